# Optimizing an MI355X kernel written in HIP

```python
import math, functools
import jax, jax.numpy as jnp
from jax import lax
import numpy as np

D_MODEL = 2048
BATCH = 16
SEQ = 2048
DEPTH = 2

GRID_W = 64
CTX_LEN = 256
Q_BLOCK = 128
ROPE_THETA = 10000.0
NORM_EPS = 1e-6
D_FF = 5632
N_SUB = 3
HALF_STEP = 0.5
N_EVEN = (DEPTH + 1) // 2
N_ODD = DEPTH // 2
DEEPNORM_ALPHA = (2 * DEPTH) ** 0.25
DEEPNORM_BETA = (8 * DEPTH) ** -0.25

MLA_HEADS = 8
MLA_Q_RANK = 512
MLA_KV_RANK = 256
MLA_NOPE = 128
MLA_ROPE = 64
MLA_V = 128
MLA_SCALE = (MLA_NOPE + MLA_ROPE) ** -0.5
GQA_HEADS = 8
GQA_KV_HEADS = 2
GQA_HEAD_DIM = 128
GQA_SCALE = GQA_HEAD_DIM ** -0.5
DIFF_HEADS = 8
DIFF_HEAD_DIM = 128
DIFF_SCALE = DIFF_HEAD_DIM ** -0.5

EVEN_SPLITS = (MLA_Q_RANK, MLA_KV_RANK, MLA_ROPE, GQA_HEADS * GQA_HEAD_DIM,
               GQA_KV_HEADS * GQA_HEAD_DIM, GQA_KV_HEADS * GQA_HEAD_DIM)
EVEN_IN = MLA_Q_RANK + MLA_KV_RANK + MLA_ROPE + (GQA_HEADS + 2 * GQA_KV_HEADS) * GQA_HEAD_DIM
EVEN_OUT = MLA_HEADS * MLA_V + GQA_HEADS * GQA_HEAD_DIM
DIFF_IN = 3 * DIFF_HEADS * 2 * DIFF_HEAD_DIM
DIFF_OUT = DIFF_HEADS * 2 * DIFF_HEAD_DIM

kernel_name = "hybrid_mla_gqa_diffattn_macaron_dit"


def layer_norm(x, g, b):
    xf = x.astype(jnp.float32)
    mu = jnp.mean(xf, -1, keepdims=True)
    var = jnp.mean(jnp.square(xf - mu), -1, keepdims=True)
    return ((xf - mu) * lax.rsqrt(var + NORM_EPS) * g + b).astype(x.dtype)


def rms_norm(x, g):
    xf = x.astype(jnp.float32)
    return (xf * lax.rsqrt(jnp.mean(xf * xf, -1, keepdims=True) + NORM_EPS) * g).astype(x.dtype)


def swiglu(h, w1, w3, w2):
    return (jax.nn.silu(h @ w1) * (h @ w3)) @ w2


def modulate(h, mod, j):
    return h * (1 + mod[:, j, 1]) + mod[:, j, 0]


def post_norm_residual(xs, mod, j, y, g, b):
    return layer_norm(DEEPNORM_ALPHA * xs + mod[:, j, 2] * y, g, b)


def ffn_half_step(xs, mod, j, w1, w3, w2, g, b):
    y = HALF_STEP * swiglu(modulate(xs, mod, j), w1, w3, w2)
    return post_norm_residual(xs, mod, j, y, g, b)


def axial_rope(rows, rot_dim):
    r, col = jnp.meshgrid(jnp.arange(rows, dtype=jnp.float32),
                          jnp.arange(GRID_W, dtype=jnp.float32), indexing="ij")
    n_freq = rot_dim // 4
    inv_freq = ROPE_THETA ** (-jnp.arange(n_freq, dtype=jnp.float32) / n_freq)
    ang = jnp.concatenate([r.reshape(-1, 1) * inv_freq, col.reshape(-1, 1) * inv_freq], -1)
    return jnp.cos(ang), jnp.sin(ang)


def apply_rope(x, cos, sin):
    half = x.shape[-1] // 2
    xf = x.astype(jnp.float32)
    x1, x2 = xf[..., :half], xf[..., half:]
    cs, sn = cos[None, :, None, :], sin[None, :, None, :]
    return jnp.concatenate([x1 * cs - x2 * sn, x2 * cs + x1 * sn], -1).astype(x.dtype)


def flatten_heads(y):
    return y.reshape(y.shape[0], y.shape[1], -1)


def sweep_query_blocks(fn, q):
    b, n = q.shape[:2]
    nb = n // Q_BLOCK
    blocks = jnp.moveaxis(q.reshape(b, nb, Q_BLOCK, *q.shape[2:]), 1, 0)
    out = lax.map(fn, blocks)
    return jnp.moveaxis(out, 0, 1).reshape(b, n, *out.shape[3:])


def grouped_softmax_attention(q, k, v, scale):
    s = jnp.einsum("bqhgd,bkhd->bhgqk", q, k, preferred_element_type=jnp.float32) * scale
    p = jax.nn.softmax(s, axis=-1).astype(v.dtype)
    return jnp.einsum("bhgqk,bkhd->bqhgd", p, v)


def diff_softmax_attention(q, k, v, lam):
    s = jnp.einsum("bqhjd,bkhjd->bhjqk", q, k, preferred_element_type=jnp.float32) * DIFF_SCALE
    p = jax.nn.softmax(s, axis=-1)
    a = (p[:, :, 0] - lam * p[:, :, 1]).astype(v.dtype)
    return jnp.einsum("bhqk,bkhd->bqhd", a, v)


def two_stream_attention(attend, q, k, v, q_c, k_c, v_c, need_ctx):
    k_all = jnp.concatenate([k_c, k], axis=1)
    v_all = jnp.concatenate([v_c, v], axis=1)
    y = sweep_query_blocks(lambda qb: attend(qb, k_all, v_all), q)
    y_c = attend(q_c, k_c, v_c) if need_ctx else None
    return y, y_c


def split_even(z):
    cuts = np.cumsum(EVEN_SPLITS)[:-1].tolist()
    return jnp.split(z, cuts, axis=-1)


def mla_qkv(cq, ckv, kr, g_cq, g_ckv, w_uq, w_ukv, rope):
    b, n = cq.shape[:2]
    q = (rms_norm(cq, g_cq) @ w_uq).reshape(b, n, MLA_HEADS, MLA_NOPE + MLA_ROPE)
    kv = (rms_norm(ckv, g_ckv) @ w_ukv).reshape(b, n, MLA_HEADS, MLA_NOPE + MLA_V)
    q_nope, q_rot = q[..., :MLA_NOPE], q[..., MLA_NOPE:]
    k_nope, v = kv[..., :MLA_NOPE], kv[..., MLA_NOPE:]
    k_rot = kr[:, :, None, :]
    if rope is not None:
        q_rot = apply_rope(q_rot, *rope)
        k_rot = apply_rope(k_rot, *rope)
    k = jnp.concatenate([k_nope, jnp.broadcast_to(k_rot, (b, n, MLA_HEADS, MLA_ROPE))], -1)
    q = jnp.concatenate([q_nope, q_rot], -1)
    return q[:, :, :, None, :], k, v


def gqa_qkv(q, k, v, g_q, g_k, rope):
    b, n = q.shape[:2]
    q = rms_norm(q.reshape(b, n, GQA_HEADS, GQA_HEAD_DIM), g_q)
    k = rms_norm(k.reshape(b, n, GQA_KV_HEADS, GQA_HEAD_DIM), g_k)
    v = v.reshape(b, n, GQA_KV_HEADS, GQA_HEAD_DIM)
    if rope is not None:
        q = apply_rope(q, *rope)
        k = apply_rope(k, *rope)
    q = q.reshape(b, n, GQA_KV_HEADS, GQA_HEADS // GQA_KV_HEADS, GQA_HEAD_DIM)
    return q, k, v


def mla_gqa_mixer(h_lat, h_ctx, rope_mla, rope_gqa, w_in, g_cq, g_ckv, w_uq, w_ukv,
                  g_q, g_k, w_o, need_ctx):
    def project(h, rope_a, rope_b):
        cq, ckv, kr, qb, kb, vb = split_even(h @ w_in)
        return (mla_qkv(cq, ckv, kr, g_cq, g_ckv, w_uq, w_ukv, rope_a),
                gqa_qkv(qb, kb, vb, g_q, g_k, rope_b))

    (qa, ka, va), (qb, kb, vb) = project(h_lat, rope_mla, rope_gqa)
    (qa_c, ka_c, va_c), (qb_c, kb_c, vb_c) = project(h_ctx, None, None)
    att_a = functools.partial(grouped_softmax_attention, scale=MLA_SCALE)
    att_b = functools.partial(grouped_softmax_attention, scale=GQA_SCALE)
    ya, ya_c = two_stream_attention(att_a, qa, ka, va, qa_c, ka_c, va_c, need_ctx)
    yb, yb_c = two_stream_attention(att_b, qb, kb, vb, qb_c, kb_c, vb_c, need_ctx)

    def merge(a, bb):
        return jnp.concatenate([flatten_heads(a), flatten_heads(bb)], -1) @ w_o

    return merge(ya, yb), (merge(ya_c, yb_c) if need_ctx else None)


def diff_mixer(h_lat, h_ctx, rope, w_in, lq1, lk1, lq2, lk2, g_sub, w_o, lambda_init, need_ctx):
    lam = (jnp.exp(jnp.sum(lq1.astype(jnp.float32) * lk1.astype(jnp.float32)))
           - jnp.exp(jnp.sum(lq2.astype(jnp.float32) * lk2.astype(jnp.float32))) + lambda_init)

    def project(h, rp):
        b, n = h.shape[:2]
        q, k, v = jnp.split(h @ w_in, 3, axis=-1)
        q = q.reshape(b, n, 2 * DIFF_HEADS, DIFF_HEAD_DIM)
        k = k.reshape(b, n, 2 * DIFF_HEADS, DIFF_HEAD_DIM)
        if rp is not None:
            q = apply_rope(q, *rp)
            k = apply_rope(k, *rp)
        q = q.reshape(b, n, DIFF_HEADS, 2, DIFF_HEAD_DIM)
        k = k.reshape(b, n, DIFF_HEADS, 2, DIFF_HEAD_DIM)
        v = v.reshape(b, n, DIFF_HEADS, 2 * DIFF_HEAD_DIM)
        return q, k, v

    q, k, v = project(h_lat, rope)
    q_c, k_c, v_c = project(h_ctx, None)
    attend = lambda qq, kk, vv: diff_softmax_attention(qq, kk, vv, lam)
    y, y_c = two_stream_attention(attend, q, k, v, q_c, k_c, v_c, need_ctx)

    def finish(yy):
        return flatten_heads(rms_norm(yy, g_sub) * (1.0 - lambda_init)) @ w_o

    return finish(y), (finish(y_c) if need_ctx else None)


def setup_inputs(seed: int = 0) -> dict:
    key = jax.random.key(seed)
    ks = iter(jax.random.split(key, 32))
    nrm = lambda shape, scale: jax.random.normal(next(ks), shape, jnp.float32) * scale
    gain = lambda shape: 1.0 + nrm(shape, 0.02)
    D, F = D_MODEL, D_FF
    return {
        "x": nrm((BATCH, SEQ, D), 1.0),
        "c": nrm((BATCH, D), 1.0),
        "ctx": nrm((BATCH, CTX_LEN, D), 1.0),
        "c_ctx": nrm((D,), 1.0),
        "w_ada": nrm((DEPTH, D, N_SUB * 3 * D), D ** -0.5),
        "b_ada": nrm((DEPTH, N_SUB * 3 * D), 0.02),
        "ln_g": gain((DEPTH, N_SUB, D)),
        "ln_b": nrm((DEPTH, N_SUB, D), 0.02),
        "ffn_w1": nrm((DEPTH, 2, D, F), D ** -0.5),
        "ffn_w3": nrm((DEPTH, 2, D, F), D ** -0.5),
        "ffn_w2": nrm((DEPTH, 2, F, D), DEEPNORM_BETA * F ** -0.5),
        "mg_w_in": nrm((N_EVEN, D, EVEN_IN), D ** -0.5),
        "mla_g_cq": gain((N_EVEN, MLA_Q_RANK)),
        "mla_g_ckv": gain((N_EVEN, MLA_KV_RANK)),
        "mla_w_uq": nrm((N_EVEN, MLA_Q_RANK, MLA_HEADS * (MLA_NOPE + MLA_ROPE)), MLA_Q_RANK ** -0.5),
        "mla_w_ukv": nrm((N_EVEN, MLA_KV_RANK, MLA_HEADS * (MLA_NOPE + MLA_V)), MLA_KV_RANK ** -0.5),
        "gqa_g_q": gain((N_EVEN, GQA_HEAD_DIM)),
        "gqa_g_k": gain((N_EVEN, GQA_HEAD_DIM)),
        "mg_w_o": nrm((N_EVEN, EVEN_OUT, D), DEEPNORM_BETA * EVEN_OUT ** -0.5),
        "diff_w_in": nrm((N_ODD, D, DIFF_IN), D ** -0.5),
        "diff_lq1": nrm((N_ODD, DIFF_HEAD_DIM), 0.1),
        "diff_lk1": nrm((N_ODD, DIFF_HEAD_DIM), 0.1),
        "diff_lq2": nrm((N_ODD, DIFF_HEAD_DIM), 0.1),
        "diff_lk2": nrm((N_ODD, DIFF_HEAD_DIM), 0.1),
        "diff_g_sub": gain((N_ODD, 2 * DIFF_HEAD_DIM)),
        "diff_w_o": nrm((N_ODD, DIFF_OUT, D), DEEPNORM_BETA * DIFF_OUT ** -0.5),
    }


def reference(x, c, ctx, c_ctx, w_ada, b_ada, ln_g, ln_b, ffn_w1, ffn_w3, ffn_w2,
              mg_w_in, mla_g_cq, mla_g_ckv, mla_w_uq, mla_w_ukv, gqa_g_q, gqa_g_k, mg_w_o,
              diff_w_in, diff_lq1, diff_lk1, diff_lq2, diff_lk2, diff_g_sub, diff_w_o):
    b, n, d = x.shape
    rows = n // GRID_W
    rope_mla = axial_rope(rows, MLA_ROPE)
    rope_gqa = axial_rope(rows, GQA_HEAD_DIM)
    rope_diff = axial_rope(rows, DIFF_HEAD_DIM)
    s_lat = jax.nn.silu(c)
    s_ctx = jax.nn.silu(c_ctx)[None]
    x_lat, x_ctx = x, ctx
    for i in range(DEPTH):
        need_ctx = i < DEPTH - 1
        mod_lat = (s_lat @ w_ada[i] + b_ada[i]).reshape(b, N_SUB, 3, 1, d)
        mod_ctx = (s_ctx @ w_ada[i] + b_ada[i]).reshape(1, N_SUB, 3, 1, d)

        x_lat = ffn_half_step(x_lat, mod_lat, 0, ffn_w1[i, 0], ffn_w3[i, 0], ffn_w2[i, 0], ln_g[i, 0], ln_b[i, 0])
        x_ctx = ffn_half_step(x_ctx, mod_ctx, 0, ffn_w1[i, 0], ffn_w3[i, 0], ffn_w2[i, 0], ln_g[i, 0], ln_b[i, 0])

        h_lat = modulate(x_lat, mod_lat, 1)
        h_ctx = modulate(x_ctx, mod_ctx, 1)
        if i % 2 == 0:
            e = i // 2
            y_lat, y_ctx = mla_gqa_mixer(h_lat, h_ctx, rope_mla, rope_gqa, mg_w_in[e], mla_g_cq[e],
                                         mla_g_ckv[e], mla_w_uq[e], mla_w_ukv[e], gqa_g_q[e],
                                         gqa_g_k[e], mg_w_o[e], need_ctx)
        else:
            o = i // 2
            lambda_init = 0.8 - 0.6 * math.exp(-0.3 * i)
            y_lat, y_ctx = diff_mixer(h_lat, h_ctx, rope_diff, diff_w_in[o], diff_lq1[o], diff_lk1[o],
                                      diff_lq2[o], diff_lk2[o], diff_g_sub[o], diff_w_o[o],
                                      lambda_init, need_ctx)
        x_lat = post_norm_residual(x_lat, mod_lat, 1, y_lat, ln_g[i, 1], ln_b[i, 1])

        x_lat = ffn_half_step(x_lat, mod_lat, 2, ffn_w1[i, 1], ffn_w3[i, 1], ffn_w2[i, 1], ln_g[i, 2], ln_b[i, 2])
        if need_ctx:
            x_ctx = post_norm_residual(x_ctx, mod_ctx, 1, y_ctx, ln_g[i, 1], ln_b[i, 1])
            x_ctx = ffn_half_step(x_ctx, mod_ctx, 2, ffn_w1[i, 1], ffn_w3[i, 1], ffn_w2[i, 1], ln_g[i, 2], ln_b[i, 2])
    return x_lat
```

```cpp
#include <hip/hip_runtime.h>
#include <cstdio>
#include <cstdint>

#define LAS __attribute__((address_space(3)))
#define GAS __attribute__((address_space(1)))
typedef unsigned short bf16;
typedef short bf16x8 __attribute__((ext_vector_type(8)));
typedef short s16x4 __attribute__((ext_vector_type(4)));
typedef float f32x4 __attribute__((ext_vector_type(4)));
typedef float f32x2 __attribute__((ext_vector_type(2)));
typedef float f32x16 __attribute__((ext_vector_type(16)));
typedef unsigned u32x4 __attribute__((ext_vector_type(4)));
typedef unsigned u32x2 __attribute__((ext_vector_type(2)));
typedef GAS unsigned gu32;

constexpr int DM = 2048, FF = 5632, NB = 16, SEQ = 2048, CTXL = 256;
constexpr int M_LAT = NB * SEQ, M_CTX = NB * CTXL, M_ALL = M_LAT + M_CTX;
constexpr int NSTREAM = 17, MODW = 9 * DM;
constexpr float LN_EPS = 1e-6f, DN_ALPHA = 1.41421356237309515f;
constexpr float LAMBDA_INIT = 0.35550906759f;
constexpr int INE_LD = 2560;
constexpr int INO_LD = 6144;
constexpr int NWAVES = 8;

constexpr size_t MiB = 1u << 20;
constexpr size_t WS_CTL = 0, CTL_ZERO_BYTES = 1 * MiB;
constexpr size_t WS_T64C = 1 * MiB, WS_T64S = WS_T64C + 256 * 1024, WS_T128C = WS_T64S + 256 * 1024, WS_T128S = WS_T128C + 512 * 1024;
constexpr size_t WS_MOD = 3 * MiB;
constexpr size_t WS_RSTD = 6 * MiB;
constexpr size_t WS_WUP = 8 * MiB, SZ_WUP = 44 * MiB;
constexpr size_t WS_WDN = WS_WUP + 4 * SZ_WUP, SZ_WDN = 22 * MiB;
constexpr size_t WS_WINE = WS_WDN + 4 * SZ_WDN;
constexpr size_t WS_WUQ = WS_WINE + 10 * MiB;
constexpr size_t WS_WUKV = WS_WUQ + 3 * MiB / 2;
constexpr size_t WS_WOE = WS_WUKV + 1 * MiB;
constexpr size_t WS_WINO = WS_WOE + 8 * MiB;
constexpr size_t WS_WOO = WS_WINO + 24 * MiB;
constexpr size_t WS_XCTX = 325 * MiB;
constexpr size_t WS_H = 357 * MiB;
constexpr size_t WS_R = 501 * MiB;
constexpr size_t WS_G = WS_R;
constexpr size_t WS_INE = WS_R;
constexpr size_t WS_KMLA = WS_INE + 180 * MiB;
constexpr size_t WS_VMLA = WS_KMLA + 108 * MiB;
constexpr size_t WS_QMLA = WS_VMLA + 72 * MiB;
constexpr size_t WS_OD = WS_H;
constexpr size_t WS_INO = WS_R + 112 * MiB;
constexpr size_t WS_END = WS_INO + 432 * MiB;
static_assert(WS_WOO + 8 * MiB <= WS_XCTX && WS_XCTX + 32 * MiB <= WS_H && WS_H + 144 * MiB <= WS_R && WS_QMLA + 108 * MiB <= WS_END && WS_G + 396 * MiB <= WS_END, "ws map");
constexpr int CW_TMO = 0, CW_CODE = 1, CW_QUEUE = 64, CW_BAR = 4096;

constexpr int LDS_BYTES = 163840;
constexpr int MISC_OFF = LDS_BYTES - 256;
constexpr int PRO_SV_OFF = 0, PRO_RED_OFF = 139264;

#define RLX_AGENT __ATOMIC_RELAXED, __HIP_MEMORY_SCOPE_AGENT
__device__ __forceinline__ unsigned cvt_pk_bf16(float lo, float hi) { unsigned r; asm volatile("v_cvt_pk_bf16_f32 %0, %1, %2" : "=v"(r) : "v"(lo), "v"(hi)); return r; }
__device__ __forceinline__ float bf2f(unsigned short b) { return __uint_as_float(((unsigned)b) << 16); }
__device__ __forceinline__ float bflo(unsigned w) { return __uint_as_float(w << 16); }
__device__ __forceinline__ float bfhi(unsigned w) { return __uint_as_float(w & 0xffff0000u); }
__device__ __forceinline__ float wave_sum(float v) {
#pragma unroll
    for (int o = 1; o < 64; o <<= 1) v += __shfl_xor(v, o);
    return v;
}
__device__ __forceinline__ float fast_silu(float a) { return a * __builtin_amdgcn_rcpf(1.0f + __builtin_amdgcn_exp2f(-1.4426950408889634f * a)); }

namespace pg8 {
constexpr int BM = 256, BK = 64, HALF = 128, HTB = HALF * BK * 2, STAGE_BYTES = 8 * HTB, NXCD = 8, WGM = 8;
__host__ __device__ __forceinline__ int lds_byte(int r, int c) { const int st = (r >> 4) * 2 + (c >> 5), rr = r & 15, cc = c & 31, ob = rr * 64 + cc * 2; return st * 1024 + (ob ^ (((ob >> 9) & 1) << 5)); }
__host__ __device__ __forceinline__ void stage_rc(int b, int& R, int& C) { const int st = b / 1024, sb = b % 1024, swz = sb ^ (((sb >> 9) & 1) << 5); R = (st >> 1) * 16 + swz / 64; C = (st & 1) * 32 + (swz % 64) / 2; }
__host__ __device__ __forceinline__ int perm32(int rho) { const int n = rho >> 4, i = rho & 15; return 8 * (i >> 2) + 4 * n + (i & 3); }
struct Unit { int pm, pn; };
struct Gemm { const bf16* A; const bf16* Bt; int M, N, K, lda, ldb; };
struct StaticOrder {
    int nM, nN, nwg, G, c;
    __device__ __forceinline__ void init(int M, int N, int G_, int c_) { nM = M / BM; nN = N / BM; nwg = nM * nN; G = G_; c = c_; }
    __device__ __forceinline__ bool next(int i, Unit& u) const {
        const long L = (long)i * G + c; if (L >= nwg) return false;
        int wgid = (int)L; { const int q = nwg / NXCD, r = nwg % NXCD, xcd = wgid % NXCD, off = wgid / NXCD; wgid = (xcd < r ? xcd * (q + 1) : r * (q + 1) + (xcd - r) * q) + off; }
        const int nig = WGM * nN, gid = wgid / nig, fm = gid * WGM, gsz = (nM - fm) < WGM ? (nM - fm) : WGM;
        u.pm = fm + ((wgid % nig) % gsz); u.pn = (wgid % nig) / gsz; return true;
    }
};
struct EpiStore {
    static constexpr bool PERM = true;
    bf16* P0; bf16* P1; int ld0, ld1, cs0, cs1; const float* rowscale;
    __device__ __forceinline__ void operator()(const f32x4 (&acc)[2][2][4][2], const Unit& u, int wr, int wc, int fr, int fq) const {
        const int row0 = u.pm * BM + wr * 64 + fr, cin = wc * 32 + 8 * fq;
#pragma unroll
        for (int ai = 0; ai < 2; ++ai)
#pragma unroll
            for (int m = 0; m < 4; ++m) { const int row = row0 + ai * HALF + m * 16; const float rs = rowscale ? rowscale[row] : 1.0f;
#pragma unroll
                for (int bj = 0; bj < 2; ++bj) { const f32x4 v0 = acc[ai][bj][m][0] * rs, v1 = acc[ai][bj][m][1] * rs;
                    u32x4 w; w.x = cvt_pk_bf16(v0[0], v0[1]); w.y = cvt_pk_bf16(v0[2], v0[3]); w.z = cvt_pk_bf16(v1[0], v1[1]); w.w = cvt_pk_bf16(v1[2], v1[3]);
                    bf16* dst = bj ? (P1 + (size_t)row * ld1 + u.pn * cs1 + cin) : (P0 + (size_t)row * ld0 + u.pn * cs0 + cin);
                    *(u32x4*)dst = w; } }
    }
};
struct EpiSwiglu {
    static constexpr bool PERM = true;
    bf16* Gd; int ldg;
    __device__ __forceinline__ void operator()(const f32x4 (&acc)[2][2][4][2], const Unit& u, int wr, int wc, int fr, int fq) const {
        const int row0 = u.pm * BM + wr * 64 + fr, col = u.pn * HALF + wc * 32 + 8 * fq;
#pragma unroll
        for (int ai = 0; ai < 2; ++ai)
#pragma unroll
            for (int m = 0; m < 4; ++m) { bf16* dst = Gd + (size_t)(row0 + ai * HALF + m * 16) * ldg + col;
                const f32x4 a0 = acc[ai][0][m][0], a1 = acc[ai][0][m][1], b0 = acc[ai][1][m][0], b1 = acc[ai][1][m][1];
                u32x4 w; w.x = cvt_pk_bf16(fast_silu(a0[0]) * b0[0], fast_silu(a0[1]) * b0[1]); w.y = cvt_pk_bf16(fast_silu(a0[2]) * b0[2], fast_silu(a0[3]) * b0[3]);
                w.z = cvt_pk_bf16(fast_silu(a1[0]) * b1[0], fast_silu(a1[1]) * b1[1]); w.w = cvt_pk_bf16(fast_silu(a1[2]) * b1[2], fast_silu(a1[3]) * b1[3]);
                *(u32x4*)dst = w; }
    }
};
struct EpiResid {
    static constexpr bool PERM = false;
    const float* xin_lat; const float* xin_ctx; float* out_lat; float* out_ctx; const float* gate_base; float hs;
    __device__ __forceinline__ void operator()(const f32x4 (&acc)[2][2][4][2], const Unit& u, int wr, int wc, int fr, int fq) const {
        const bool lat = u.pm < 128; const int s = lat ? (u.pm >> 3) : 16; const int rb = (lat ? u.pm : u.pm - 128) * BM + wr * 64 + fr;
        const float* xin = lat ? xin_lat : xin_ctx; float* out = lat ? out_lat : out_ctx;
        const int col0 = u.pn * BM + wc * 32 + 4 * fq; const float* gate = gate_base + (size_t)s * MODW;
        f32x4 gv[2][2];
#pragma unroll
        for (int bj = 0; bj < 2; ++bj)
#pragma unroll
            for (int n = 0; n < 2; ++n) gv[bj][n] = *(const f32x4*)(gate + col0 + bj * HALF + n * 16) * hs;
#pragma unroll
        for (int ai = 0; ai < 2; ++ai)
#pragma unroll
            for (int m = 0; m < 4; ++m) { const size_t off = (size_t)(rb + ai * HALF + m * 16) * DM + col0;
#pragma unroll
                for (int bj = 0; bj < 2; ++bj)
#pragma unroll
                    for (int n = 0; n < 2; ++n) { const f32x4 xv = *(const f32x4*)(xin + off + bj * HALF + n * 16);
                        *(f32x4*)(out + off + bj * HALF + n * 16) = xv * DN_ALPHA + gv[bj][n] * acc[ai][bj][m][n]; }
                asm volatile("" ::: "memory"); }
    }
};

template <class Epi, class Sched>
__device__ __forceinline__ void gemm_phase(LAS unsigned char* lds, const Gemm g, const Sched& S, const Epi& E) {
    int tid_l = threadIdx.x; asm volatile("" : "+v"(tid_l));
    const int tid = tid_l, wid = __builtin_amdgcn_readfirstlane(tid >> 6), lane = tid & 63, wr = wid >> 2, wc = wid & 3, fr = lane & 15, fq = lane >> 4;
    const int K = g.K, nt = K / BK;
    unsigned voffA[2], voffB[2];
#pragma unroll
    for (int i = 0; i < 2; ++i) { int R, C; stage_rc(tid * 16 + i * 8192, R, C); const int Rb = Epi::PERM ? ((R & ~31) + perm32(R & 31)) : R;
        voffA[i] = (unsigned)(R * g.lda + C) * 2u; voffB[i] = (unsigned)(Rb * g.ldb + C) * 2u; }
    const size_t kstep = (size_t)(BK * 2);
    const size_t hsA = (size_t)HALF * g.lda * 2, hsB = (size_t)HALF * g.ldb * 2;
    const size_t tsA = 2 * hsA, tsB = 2 * hsB;
    const unsigned ldsw = (unsigned)wid * 1024u;
    const int aoff = lds_byte(wr * 64 + fr, fq * 8), boff = lds_byte(wc * 32 + fr, fq * 8);
#define PG8_SA(b, h) (((b) * 2 + (h)) * HTB)
#define PG8_SB(b, h) ((4 + (b) * 2 + (h)) * HTB)
#define PG8_STAGE(bufoff, gbase, voff) do { _Pragma("unroll") for (int _i = 0; _i < 2; ++_i) \
        __builtin_amdgcn_global_load_lds((const unsigned*)((const char*)(gbase) + (voff)[_i]), (LAS unsigned*)(lds + (bufoff) + ldsw + _i * 8192), 16, 0, 0); } while (0)
#define PG8_LDA(dst, b, h) do { _Pragma("unroll") for (int m = 0; m < 4; ++m) _Pragma("unroll") for (int k = 0; k < 2; ++k) dst[m][k] = *(const LAS bf16x8*)(lds + PG8_SA(b, h) + aoff + m * 2048 + k * 1024); } while (0)
#define PG8_LDB(dst, b, h) do { _Pragma("unroll") for (int n = 0; n < 2; ++n) _Pragma("unroll") for (int k = 0; k < 2; ++k) dst[n][k] = *(const LAS bf16x8*)(lds + PG8_SB(b, h) + boff + n * 2048 + k * 1024); } while (0)
#define PG8_MMA(ai, bj, At, Bt) do { __builtin_amdgcn_s_setprio(1); _Pragma("unroll") for (int m = 0; m < 4; ++m) _Pragma("unroll") for (int n = 0; n < 2; ++n) _Pragma("unroll") for (int k = 0; k < 2; ++k) \
        acc[ai][bj][m][n] = __builtin_amdgcn_mfma_f32_16x16x32_bf16(Bt[n][k], At[m][k], acc[ai][bj][m][n], 0, 0, 0); __builtin_amdgcn_s_setprio(0); } while (0)
#define PG8_WAIT_V(n) asm volatile("s_waitcnt vmcnt(" #n ")" ::: "memory")
#define PG8_WAIT_L(n) asm volatile("s_waitcnt lgkmcnt(" #n ")" ::: "memory")
#define PG8_BAR __builtin_amdgcn_s_barrier()
#define PG8_SCHED __builtin_amdgcn_sched_barrier(0)
    Unit cur, nxt; int ui = 0;
    if (!S.next(0, cur)) return;
    f32x4 acc[2][2][4][2];
#pragma unroll
    for (int a = 0; a < 2; ++a)
#pragma unroll
        for (int b = 0; b < 2; ++b)
#pragma unroll
            for (int m = 0; m < 4; ++m)
#pragma unroll
                for (int n = 0; n < 2; ++n) acc[a][b][m][n] = (f32x4){0.f, 0.f, 0.f, 0.f};
    bf16x8 At[4][2], B0[2][2], B1[2][2];
    const char* cA = (const char*)g.A + (size_t)cur.pm * tsA; const char* cB = (const char*)g.Bt + (size_t)cur.pn * tsB;
    PG8_STAGE(PG8_SB(0, 0), cB, voffB); PG8_STAGE(PG8_SB(0, 1), cB + hsB, voffB); PG8_STAGE(PG8_SA(0, 0), cA, voffA); PG8_STAGE(PG8_SA(0, 1), cA + hsA, voffA);
    if (wr == 1) PG8_BAR;
    PG8_WAIT_V(2); PG8_BAR;
    PG8_STAGE(PG8_SB(1, 0), cB + kstep, voffB); PG8_STAGE(PG8_SA(1, 0), cA + kstep, voffA); PG8_STAGE(PG8_SB(1, 1), cB + hsB + kstep, voffB);
    PG8_WAIT_V(6); PG8_BAR;
    for (;;) {
        const bool has_next = S.next(ui + 1, nxt);
        const char* nA = has_next ? (const char*)g.A + (size_t)nxt.pm * tsA : cA; const char* nB = has_next ? (const char*)g.Bt + (size_t)nxt.pn * tsB : cB;
        for (int t = 0; t < nt; t += 2) {
            const bool last = (t == nt - 2);
            const char* a1 = cA + (size_t)(t + 1) * kstep;
            const char* a2 = last ? nA : cA + (size_t)(t + 2) * kstep; const char* b2 = last ? nB : cB + (size_t)(t + 2) * kstep;
            const char* a3 = a2 + kstep; const char* b3 = b2 + kstep;
            PG8_LDB(B0, 0, 0); PG8_LDB(B1, 0, 1); PG8_SCHED; PG8_LDA(At, 0, 0); PG8_STAGE(PG8_SA(1, 1), a1 + hsA, voffA);
            PG8_WAIT_V(8); PG8_WAIT_L(0); PG8_BAR; PG8_MMA(0, 0, At, B0); PG8_MMA(0, 1, At, B1); PG8_BAR; PG8_SCHED;
            PG8_LDA(At, 0, 1); PG8_STAGE(PG8_SB(0, 0), b2, voffB); PG8_STAGE(PG8_SB(0, 1), b2 + hsB, voffB); PG8_STAGE(PG8_SA(0, 0), a2, voffA);
            PG8_WAIT_V(8); PG8_WAIT_L(0); PG8_BAR; PG8_MMA(1, 0, At, B0); PG8_MMA(1, 1, At, B1); PG8_BAR; PG8_SCHED;
            PG8_LDB(B0, 1, 0); PG8_LDB(B1, 1, 1); PG8_SCHED; PG8_LDA(At, 1, 0); PG8_STAGE(PG8_SA(0, 1), a2 + hsA, voffA);
            PG8_WAIT_V(8); PG8_WAIT_L(0); PG8_BAR; PG8_MMA(0, 0, At, B0); PG8_MMA(0, 1, At, B1); PG8_BAR; PG8_SCHED;
            PG8_LDA(At, 1, 1); PG8_STAGE(PG8_SB(1, 0), b3, voffB); PG8_STAGE(PG8_SB(1, 1), b3 + hsB, voffB); PG8_STAGE(PG8_SA(1, 0), a3, voffA);
            PG8_WAIT_V(8); PG8_WAIT_L(0); PG8_BAR; PG8_MMA(1, 0, At, B0); PG8_MMA(1, 1, At, B1); PG8_BAR; PG8_SCHED;
        }
        if (wr == 0) PG8_BAR;
        E(acc, cur, wr, wc, fr, fq);
        if (!has_next) break;
#pragma unroll
        for (int a = 0; a < 2; ++a)
#pragma unroll
            for (int b = 0; b < 2; ++b)
#pragma unroll
                for (int m = 0; m < 4; ++m)
#pragma unroll
                    for (int n = 0; n < 2; ++n) acc[a][b][m][n] = (f32x4){0.f, 0.f, 0.f, 0.f};
        cur = nxt; cA = nA; cB = nB; ++ui;
        if (wr == 1) PG8_BAR;
    }
    PG8_WAIT_V(0);
    PG8_BAR;
#undef PG8_SA
#undef PG8_SB
#undef PG8_STAGE
#undef PG8_LDA
#undef PG8_LDB
#undef PG8_MMA
#undef PG8_WAIT_V
#undef PG8_WAIT_L
#undef PG8_BAR
#undef PG8_SCHED
}
}

#ifndef A192_NQR
#define A192_NQR 6
#endif
namespace att {
constexpr int NW = 8, QBLK = 32, KVBLK = 64;
constexpr float THR = 8.f;
constexpr int SHM_V = KVBLK * 128 * 2;
#define SBAR() __builtin_amdgcn_sched_barrier(0)
__device__ __forceinline__ int crow(int r, int hi) { return (r & 3) + 8 * (r >> 2) + 4 * hi; }
__device__ __forceinline__ unsigned cvtpk(float lo, float hi) { unsigned r; asm volatile("v_cvt_pk_bf16_f32 %0, %1, %2" : "=v"(r) : "v"(lo), "v"(hi)); return r; }
template <int DK> struct Cfg {
    static constexpr int PITCH = DK * 2, SHM_K = KVBLK * DK * 2, NCH = DK / 64, CPR = DK / 8, ND0 = DK / 16;
    static constexpr float SCALE = (DK == 192) ? 0.07216878364870322f : 0.08838834764831845f;
    static constexpr int NQR = (DK == 192) ? A192_NQR : 8;
    static constexpr int QL_WAVE = (ND0 - NQR) * 1024;
    static constexpr int LDS_NEED = 2 * SHM_V + 2 * SHM_K + NW * 64 * 4 + NW * QL_WAVE;
};
template <int DK> __device__ __forceinline__ void partialSM(f32x16& p0, f32x16& p1, float& m_reg, float& mn, float& alpha) {
  constexpr float SCALE = Cfg<DK>::SCALE; constexpr float C = SCALE * 1.4426950408889634f;
  float pmax = p0[0]; for (int r = 1; r < 16; ++r) pmax = fmaxf(pmax, p0[r]); for (int r = 0; r < 16; ++r) pmax = fmaxf(pmax, p1[r]);
  { auto rr = __builtin_amdgcn_permlane32_swap(__float_as_uint(pmax), __float_as_uint(pmax), false, false);
    pmax = fmaxf(__uint_as_float(rr[0]), __uint_as_float(rr[1])); }
  if (__builtin_expect(__all(pmax - m_reg <= THR / SCALE), 1)) { mn = m_reg; alpha = 1.f; }
  else { mn = fmaxf(m_reg, pmax); alpha = __builtin_amdgcn_exp2f((m_reg - mn) * C); m_reg = mn; }
  float mnC = -mn * C;
  for (int r = 0; r < 16; ++r) p0[r] = fmaf(p0[r], C, mnC); for (int r = 0; r < 16; ++r) p1[r] = fmaf(p1[r], C, mnC);
  for (int r = 0; r < 16; ++r) p0[r] = __builtin_amdgcn_exp2f(p0[r]);
}
__device__ __forceinline__ void finishSM(f32x16& p0, f32x16& p1, float alpha, float& l_reg, bf16x8& pa0, bf16x8& pa1, bf16x8& pa2, bf16x8& pa3) {
  for (int r = 0; r < 16; ++r) p1[r] = __builtin_amdgcn_exp2f(p1[r]);
  float ps = 0; for (int r = 0; r < 16; ++r) ps += p0[r]; for (int r = 0; r < 16; ++r) ps += p1[r];
  { auto rr = __builtin_amdgcn_permlane32_swap(__float_as_uint(ps), __float_as_uint(ps), false, false);
    ps = __uint_as_float(rr[0]) + __uint_as_float(rr[1]); }
  l_reg = l_reg * alpha + ps;
#define PK4(P, BASE, OUT) do { unsigned a0 = cvtpk(P[BASE + 0], P[BASE + 1]), a1 = cvtpk(P[BASE + 2], P[BASE + 3]);   \
    unsigned b0 = cvtpk(P[BASE + 4], P[BASE + 5]), b1 = cvtpk(P[BASE + 6], P[BASE + 7]);                              \
    auto r0 = __builtin_amdgcn_permlane32_swap(a0, b0, false, false); auto r1 = __builtin_amdgcn_permlane32_swap(a1, b1, false, false); \
    u32x4 w = {r0[0], r1[0], r0[1], r1[1]}; OUT = *reinterpret_cast<bf16x8*>(&w); } while (0)
  PK4(p0, 0, pa0); PK4(p0, 8, pa1); PK4(p1, 0, pa2); PK4(p1, 8, pa3);
#undef PK4
}
template <int DK> __device__ __forceinline__ void qkt(f32x16& p0, f32x16& p1, const LAS char* Ks, const bf16x8* qr, const LAS char* qrl, int r32, int hi) {
  constexpr int PITCH = Cfg<DK>::PITCH, NQR = Cfg<DK>::NQR;
  p0 = f32x16{}; p1 = f32x16{};
#pragma unroll
  for (int d0 = 0; d0 < Cfg<DK>::ND0; ++d0) { const int cb = (d0 * 16 + hi * 8) * 2;
    bf16x8 b0 = *reinterpret_cast<const LAS bf16x8*>(Ks + r32 * PITCH + (cb ^ ((r32 & 7) << 4)));
    bf16x8 b1 = *reinterpret_cast<const LAS bf16x8*>(Ks + (32 + r32) * PITCH + (cb ^ ((r32 & 7) << 4)));
    bf16x8 qf; if (d0 < NQR) qf = qr[d0 < NQR ? d0 : 0]; else qf = *reinterpret_cast<const LAS bf16x8*>(qrl + (d0 - NQR) * 1024);
    p0 = __builtin_amdgcn_mfma_f32_32x32x16_bf16(b0, qf, p0, 0, 0, 0);
    p1 = __builtin_amdgcn_mfma_f32_32x32x16_bf16(b1, qf, p1, 0, 0, 0); }
}
__device__ __forceinline__ int v_st(int k, int c) { const int kk = (k & ~0xC) | ((k & 4) << 1) | ((k & 8) >> 1); return ((kk >> 3) * 4 + (c >> 5)) * 512 + ((kk & 7) * 32 + (c & 31)) * 2; }
__device__ __forceinline__ int v_rd_base(int lane) { return ((lane & 3) << 3) | (((lane >> 2) & 3) << 6) | (((lane >> 4) & 1) << 5) | (((lane >> 5) & 1) << 8); }
constexpr int v_rd_off(int d0, int ks, int half) { return d0 * 512 + ks * 4096 + half * 2048; }
template <int OFF> __device__ __forceinline__ s16x4 tr_read(int vb) {
  s16x4 r; asm volatile("ds_read_b64_tr_b16 %0, %1 offset:%2" : "=&v"(r) : "v"(vb), "i"(OFF) : "memory"); return r;
}
template <int D0> __device__ __forceinline__ void pv_one(f32x16& od, int vb, bf16x8 pa0, bf16x8 pa1, bf16x8 pa2, bf16x8 pa3) {
  const s16x4 l0 = tr_read<v_rd_off(D0, 0, 0)>(vb), h0 = tr_read<v_rd_off(D0, 0, 1)>(vb), l1 = tr_read<v_rd_off(D0, 1, 0)>(vb), h1 = tr_read<v_rd_off(D0, 1, 1)>(vb);
  const s16x4 l2 = tr_read<v_rd_off(D0, 2, 0)>(vb), h2 = tr_read<v_rd_off(D0, 2, 1)>(vb), l3 = tr_read<v_rd_off(D0, 3, 0)>(vb), h3 = tr_read<v_rd_off(D0, 3, 1)>(vb);
  asm volatile("s_waitcnt lgkmcnt(0)" ::: "memory"); SBAR();
#define PK(L, H) (bf16x8){L[0], L[1], L[2], L[3], H[0], H[1], H[2], H[3]}
  od = __builtin_amdgcn_mfma_f32_32x32x16_bf16(pa0, PK(l0, h0), od, 0, 0, 0);
  od = __builtin_amdgcn_mfma_f32_32x32x16_bf16(pa1, PK(l1, h1), od, 0, 0, 0);
  od = __builtin_amdgcn_mfma_f32_32x32x16_bf16(pa2, PK(l2, h2), od, 0, 0, 0);
  od = __builtin_amdgcn_mfma_f32_32x32x16_bf16(pa3, PK(l3, h3), od, 0, 0, 0);
#undef PK
}
__device__ __forceinline__ void pv_d0(f32x16* o, int vb, bf16x8 pa0, bf16x8 pa1, bf16x8 pa2, bf16x8 pa3) {
  pv_one<0>(o[0], vb, pa0, pa1, pa2, pa3); pv_one<1>(o[1], vb, pa0, pa1, pa2, pa3); pv_one<2>(o[2], vb, pa0, pa1, pa2, pa3); pv_one<3>(o[3], vb, pa0, pa1, pa2, pa3);
}
template <int DK, bool ROPEQ, int SD>
__device__ __forceinline__ void attn_unit(const bf16* __restrict__ Qb, int ldq, const bf16* __restrict__ Kc, const bf16* __restrict__ Kl, int ldk,
                                          const bf16* __restrict__ Vc, const bf16* __restrict__ Vl, int ldv, int nc, int NT,
                                          bf16* __restrict__ Ob, int ldo, const float* rc, const float* rs, LAS char* lds) {
  constexpr int PITCH = Cfg<DK>::PITCH, SHM_K = Cfg<DK>::SHM_K, NCH = Cfg<DK>::NCH, CPR = Cfg<DK>::CPR, ND0 = Cfg<DK>::ND0;
  int tid_l = threadIdx.x; asm volatile("" : "+v"(tid_l));
  const int tid = tid_l, wid = tid >> 6, lane = tid & 63, r32 = lane & 31, hi = lane >> 5;
  LAS char* V_lds = lds; LAS char* K_lds = lds + 2 * SHM_V;
  LAS float* wsc = (LAS float*)(lds + 2 * SHM_V + 2 * SHM_K) + wid * 64; LAS float* li_l = wsc; LAS float* al_l = wsc + 32;
  constexpr int NQR = Cfg<DK>::NQR;
  LAS char* qrl = lds + 2 * SHM_V + 2 * SHM_K + NW * 64 * 4 + wid * Cfg<DK>::QL_WAVE + (hi * 32 + r32) * 16;
  float m_reg = -1e30f, l_reg = 0; f32x16 o[4] = {}; bf16x8 qr[ND0];
  const bf16* Qw = Qb + (long)(wid * QBLK + r32) * ldq + hi * 8;
#pragma unroll
  for (int d0 = 0; d0 < ND0; ++d0) qr[d0] = *reinterpret_cast<const bf16x8*>(Qw + d0 * 16);
  if constexpr (ROPEQ) {
    if (rc != nullptr) {
#pragma unroll
      for (int dd = 0; dd < 2; ++dd) { const int i0 = 16 * dd + 8 * hi; const float* cp = rc + (wid * QBLK + r32) * 32 + i0; const float* sp = rs + (wid * QBLK + r32) * 32 + i0;
        const f32x4 c0 = *(const f32x4*)cp, c1 = *(const f32x4*)(cp + 4), s0 = *(const f32x4*)sp, s1 = *(const f32x4*)(sp + 4);
        bf16x8 x1 = qr[8 + dd], x2 = qr[10 + dd]; float o1[8], o2[8];
#pragma unroll
        for (int j = 0; j < 8; ++j) { const float a = bf2f((unsigned short)x1[j]), b = bf2f((unsigned short)x2[j]); const float c = j < 4 ? c0[j & 3] : c1[j & 3], s = j < 4 ? s0[j & 3] : s1[j & 3];
          o1[j] = a * c - b * s; o2[j] = b * c + a * s; }
        u32x4 w1 = {cvtpk(o1[0], o1[1]), cvtpk(o1[2], o1[3]), cvtpk(o1[4], o1[5]), cvtpk(o1[6], o1[7])}, w2 = {cvtpk(o2[0], o2[1]), cvtpk(o2[2], o2[3]), cvtpk(o2[4], o2[5]), cvtpk(o2[6], o2[7])};
        qr[8 + dd] = *reinterpret_cast<bf16x8*>(&w1); qr[10 + dd] = *reinterpret_cast<bf16x8*>(&w2); }
    }
  }
  if constexpr (ND0 > NQR) {
#pragma unroll
    for (int d0 = NQR; d0 < ND0; ++d0) *reinterpret_cast<LAS bf16x8*>(qrl + (d0 - NQR) * 1024) = qr[d0];
    asm volatile("s_waitcnt lgkmcnt(0)" ::: "memory");
  }
  const int sr = tid >> 4, sc = (tid & 15) * 8, vst0 = v_st(sr, sc), vst1 = vst0 + 8192;
  const int vb0 = (int)(unsigned)(size_t)V_lds + v_rd_base(lane);
  const unsigned kgo = (unsigned)((tid >> 3) * ldk + (tid & 7) * 8) * 2u, kwo = (unsigned)((tid >> 3) * PITCH + (((tid & 7) * 16) ^ (((tid >> 3) & 7) << 4)));
  const unsigned vgo0 = (unsigned)(sr * ldv + sc) * 2u; const long vhs = (long)32 * ldv * 2;
  struct { bf16x8 vs0, vs1, ks[NCH]; } sr_[SD];
#define TILE_K(j) ((j) < nc ? Kc + (long)(j) * KVBLK * ldk : Kl + (long)((j) - nc) * KVBLK * ldk)
#define TILE_V(j) ((j) < nc ? Vc + (long)(j) * KVBLK * ldv : Vl + (long)((j) - nc) * KVBLK * ldv)
#define SLOAD(i, j) do { const char* _kb = (const char*)TILE_K(j); const char* _vb = (const char*)TILE_V(j); \
    sr_[i].vs0 = *reinterpret_cast<const bf16x8*>(_vb + vgo0); sr_[i].vs1 = *reinterpret_cast<const bf16x8*>(_vb + vhs + vgo0); \
    _Pragma("unroll") for (int _c = 0; _c < NCH; ++_c) sr_[i].ks[_c] = *reinterpret_cast<const bf16x8*>(_kb + _c * 128 + kgo); } while (0)
#define SWRITE(b, i) do { *(LAS bf16x8*)(V_lds + (b) * SHM_V + vst0) = sr_[i].vs0; *(LAS bf16x8*)(V_lds + (b) * SHM_V + vst1) = sr_[i].vs1; \
    _Pragma("unroll") for (int _c = 0; _c < NCH; ++_c) *(LAS bf16x8*)(K_lds + (b) * SHM_K + _c * 128 + kwo) = sr_[i].ks[_c]; } while (0)
#define SWAIT() do { if (SD == 1) asm volatile("s_waitcnt vmcnt(0)" ::: "memory"); else if (NCH == 2) asm volatile("s_waitcnt vmcnt(4)" ::: "memory"); else asm volatile("s_waitcnt vmcnt(5)" ::: "memory"); } while (0)
#define RESC(a) do { if (__any((a) < 1.f)) { if (hi == 0) al_l[r32] = (a); asm volatile("s_waitcnt lgkmcnt(0)" ::: "memory"); \
    for (int d = 0; d < 4; ++d) for (int r = 0; r < 16; ++r) o[d][r] *= al_l[crow(r, hi)]; } } while (0)
  f32x16 pA0, pA1, pB0, pB1; float mnA, mnB, alA, alB; bf16x8 pa0, pa1, pa2, pa3;
  constexpr int SE = 0, SO = SD - 1;
  SLOAD(SE, 0); asm volatile("s_waitcnt vmcnt(0)" ::: "memory"); SWRITE(0, SE); __syncthreads();
  qkt<DK>(pA0, pA1, K_lds, qr, qrl, r32, hi); partialSM<DK>(pA0, pA1, m_reg, mnA, alA);
  SLOAD(SO, 1); if constexpr (SD == 2) { if (2 < NT) SLOAD(SE, 2); }
  SWAIT(); SWRITE(1, SO); __syncthreads();
  for (int j = 1; j + 1 < NT; j += 2) {
    SBAR(); qkt<DK>(pB0, pB1, K_lds + SHM_K, qr, qrl, r32, hi);
    finishSM(pA0, pA1, alA, l_reg, pa0, pa1, pa2, pa3); SBAR();
    SLOAD(SO, j + SD); SBAR();
    pv_d0(o, vb0, pa0, pa1, pa2, pa3); partialSM<DK>(pB0, pB1, m_reg, mnB, alB);
    __syncthreads(); SWAIT(); SWRITE(0, SE);
    RESC(alB); __syncthreads();
    SBAR(); qkt<DK>(pA0, pA1, K_lds, qr, qrl, r32, hi);
    finishSM(pB0, pB1, alB, l_reg, pa0, pa1, pa2, pa3); SBAR();
    if (SD == 1 || j + 3 < NT) SLOAD(SE, j + 1 + SD); SBAR();
    pv_d0(o, vb0 + SHM_V, pa0, pa1, pa2, pa3); partialSM<DK>(pA0, pA1, m_reg, mnA, alA);
    __syncthreads(); SWAIT(); SWRITE(1, SO);
    RESC(alA); __syncthreads();
  }
  SBAR(); qkt<DK>(pB0, pB1, K_lds + SHM_K, qr, qrl, r32, hi);
  finishSM(pA0, pA1, alA, l_reg, pa0, pa1, pa2, pa3); SBAR();
  pv_d0(o, vb0, pa0, pa1, pa2, pa3); partialSM<DK>(pB0, pB1, m_reg, mnB, alB);
  __syncthreads(); RESC(alB);
  finishSM(pB0, pB1, alB, l_reg, pa0, pa1, pa2, pa3); SBAR();
  pv_d0(o, vb0 + SHM_V, pa0, pa1, pa2, pa3);
  if (hi == 0) li_l[r32] = l_reg; asm volatile("s_waitcnt lgkmcnt(0)" ::: "memory");
  float rli[16];
#pragma unroll
  for (int r = 0; r < 16; ++r) rli[r] = __builtin_amdgcn_rcpf(li_l[crow(r, hi)]);
  bf16* Ow = Ob + (long)(wid * QBLK) * ldo;
#pragma unroll
  for (int r = 0; r < 16; ++r) { const int orow = crow(r, hi);
#pragma unroll
    for (int d0 = 0; d0 < 4; ++d0) Ow[(long)orow * ldo + d0 * 32 + r32] = (bf16)(cvtpk(o[d0][r] * rli[r], 0.f) & 0xffffu); }
  __syncthreads();
#undef TILE_K
#undef TILE_V
#undef SLOAD
#undef SWRITE
#undef SWAIT
#undef RESC
}
}

#define XB_TMO      128
#define XB_XCNT(j)  (256  + 64 * (j))
#define XB_XSUB(j)  (1280 + 64 * (j))
#define XB_XGEN(j)  (2304 + 64 * (j))
#define XB_TOP      3328
#define XB_TOPGEN   3392
#define XCD_BAR_WORDS 3456
#define XB_SPIN_CAP (1u << 22)
__device__ __forceinline__ unsigned xb_ld(unsigned* p)              { return __hip_atomic_load(p, __ATOMIC_RELAXED, __HIP_MEMORY_SCOPE_AGENT); }
__device__ __forceinline__ unsigned xb_add(unsigned* p, unsigned v) { return __hip_atomic_fetch_add(p, v, __ATOMIC_RELAXED, __HIP_MEMORY_SCOPE_AGENT); }
__device__ __forceinline__ unsigned xb_xcc_id() { return (unsigned)__builtin_amdgcn_s_getreg((3 << 11) | 20) & 0xFu; }
#define XB_SPIN(cond, bar) do { unsigned _sp = 0; while (cond) { __builtin_amdgcn_s_sleep(1); \
    if ((++_sp & 255u) == 0u) { if (xb_ld(&(bar)[XB_TMO])) break; if (_sp > XB_SPIN_CAP) { atomicAdd(&(bar)[XB_TMO], 1u); break; } } } } while (0)
struct XcdBarrier { unsigned* bar; unsigned x; volatile LAS unsigned* st; };
__device__ __forceinline__ XcdBarrier xcd_barrier_post(unsigned* bar, volatile LAS unsigned* st) {
    XcdBarrier b; b.bar = bar; b.x = xb_xcc_id(); b.st = st;
    if (threadIdx.x == 0) (void)xb_add(&bar[XB_XCNT(b.x)], 1u);
    return b;
}
__device__ __forceinline__ void xcd_barrier_complete(unsigned* bar, unsigned x, unsigned& nloc, unsigned& nx) {
    const unsigned G = gridDim.x * gridDim.y * gridDim.z;
    unsigned sum, cnt, mine, sp = 0u;
    for (;;) {
        sum = 0u; cnt = 0u; mine = 0u;
#pragma unroll
        for (unsigned j = 0; j < 16; ++j) { const unsigned c = xb_ld(&bar[XB_XCNT(j)]); sum += c; cnt += (c > 0u) ? 1u : 0u; mine = (j == x) ? c : mine; }
        if (sum == G) break;
        __builtin_amdgcn_s_sleep(1);
        if ((++sp & 255u) == 0u) { if (xb_ld(&bar[XB_TMO])) break; if (sp > XB_SPIN_CAP) { atomicAdd(&bar[XB_TMO], 1u); break; } }
    }
    nloc = mine > 0u ? mine : 1u; nx = cnt > 0u ? cnt : 1u;
}
__device__ __forceinline__ void xcd_barrier(const XcdBarrier& b) {
    asm volatile("s_waitcnt vmcnt(0)" ::: "memory");
    __syncthreads();
    if (threadIdx.x == 0) {
        unsigned* bar = b.bar;
        __builtin_amdgcn_s_waitcnt(0);
        unsigned nloc = b.st[0], nx = b.st[1];
        if (nloc == 0u) { xcd_barrier_complete(bar, b.x, nloc, nx); b.st[0] = nloc; b.st[1] = nx; }
        const unsigned old = xb_add(&bar[XB_XSUB(b.x)], 1u);
        const unsigned gen = old / nloc;
        if (old + 1u == (gen + 1u) * nloc) {
            __builtin_amdgcn_fence(__ATOMIC_RELEASE, "agent");
            asm volatile("s_waitcnt vmcnt(0)" ::: "memory");
            const unsigned og = xb_add(&bar[XB_TOP], 1u);
            const unsigned tg = og / nx;
            if (og + 1u == (tg + 1u) * nx) xb_add(&bar[XB_TOPGEN], 1u);
            else XB_SPIN(xb_ld(&bar[XB_TOPGEN]) == tg, bar);
            __builtin_amdgcn_fence(__ATOMIC_ACQUIRE, "agent");
            xb_add(&bar[XB_XGEN(b.x)], 1u);
            asm volatile("s_waitcnt vmcnt(0)" ::: "memory");
        } else {
            XB_SPIN(xb_ld(&bar[XB_XGEN(b.x)]) == gen, bar);
            __builtin_amdgcn_fence(__ATOMIC_ACQUIRE, "agent");
            asm volatile("s_waitcnt vmcnt(0)" ::: "memory");
        }
    }
    __syncthreads();
}

struct Args { const float* in[26]; float* out; unsigned char* ws; };

__device__ __forceinline__ void transpose_item(const float* W, int K, int N, bf16* WT, int k0, int n0, int drow0, const float* ksc, LAS float* scr, int lane) {
#pragma unroll 8
    for (int i = 0; i < 32; ++i) { const int kk = 2 * i + (lane >> 5); float v = W[(size_t)(k0 + kk) * N + n0 + (lane & 31)]; if (ksc) v *= ksc[k0 + kk]; scr[kk * 33 + (lane & 31)] = v; }
    asm volatile("s_waitcnt lgkmcnt(0)" ::: "memory");
    const int c = lane & 7;
#pragma unroll
    for (int j = 0; j < 4; ++j) { const int n = (lane >> 3) + 8 * j; const LAS float* s = scr + (8 * c) * 33 + n;
        u32x4 o; o.x = cvt_pk_bf16(s[0 * 33], s[1 * 33]); o.y = cvt_pk_bf16(s[2 * 33], s[3 * 33]); o.z = cvt_pk_bf16(s[4 * 33], s[5 * 33]); o.w = cvt_pk_bf16(s[6 * 33], s[7 * 33]);
        *(u32x4*)(WT + (size_t)(drow0 + n) * K + k0 + 8 * c) = o; }
    asm volatile("s_waitcnt lgkmcnt(0)" ::: "memory");
}
constexpr int NMAT = 18;
__device__ __forceinline__ int mat_items(int id) { return id < 12 ? 5632 : id == 12 ? 2368 : id == 13 ? 384 : id == 14 ? 256 : id == 15 ? 2048 : id == 16 ? 6144 : 2048; }
constexpr int CONV_ITEMS = 12 * 5632 + 2368 + 384 + 256 + 2048 + 6144 + 2048;
constexpr int CONV_CHUNK = 64, N_CONV_CHUNKS = CONV_ITEMS / CONV_CHUNK;
constexpr int N_GEMV_TASKS = 2 * 144, N_TAB_TASKS = 24;
constexpr int T_CONV0 = N_GEMV_TASKS, T_PAD = T_CONV0 + N_CONV_CHUNKS, T_TAB0 = T_PAD + 1, N_TASKS = T_TAB0 + N_TAB_TASKS;

__device__ __forceinline__ void conv_item(const Args& a, int item, LAS float* scr, int lane) {
    int id = 0, it = item;
#pragma unroll 1
    for (; id < NMAT; ++id) { const int n = mat_items(id); if (it < n) break; it -= n; }
    const float* W; int K, N; bf16* WT; int kind = 0; const float* ksc = nullptr; unsigned char* ws = a.ws;
    if (id < 4)       { W = a.in[8] + (size_t)id * DM * FF;        K = DM; N = FF; WT = (bf16*)(ws + WS_WUP + (size_t)id * SZ_WUP); kind = 1; }
    else if (id < 8)  { W = a.in[9] + (size_t)(id - 4) * DM * FF;  K = DM; N = FF; WT = (bf16*)(ws + WS_WUP + (size_t)(id - 4) * SZ_WUP); kind = 2; }
    else if (id < 12) { W = a.in[10] + (size_t)(id - 8) * FF * DM; K = FF; N = DM; WT = (bf16*)(ws + WS_WDN + (size_t)(id - 8) * SZ_WDN); }
    else if (id == 12) { W = a.in[11]; K = DM; N = 2368; WT = (bf16*)(ws + WS_WINE); kind = 3; }
    else if (id == 13) { W = a.in[14]; K = 512; N = 1536; WT = (bf16*)(ws + WS_WUQ); ksc = a.in[12]; }
    else if (id == 14) { W = a.in[15]; K = 256; N = 2048; WT = (bf16*)(ws + WS_WUKV); ksc = a.in[13]; }
    else if (id == 15) { W = a.in[18]; K = DM; N = DM; WT = (bf16*)(ws + WS_WOE); }
    else if (id == 16) { W = a.in[19]; K = DM; N = INO_LD; WT = (bf16*)(ws + WS_WINO); }
    else               { W = a.in[25]; K = DM; N = DM; WT = (bf16*)(ws + WS_WOO); }
    const int nblk = N / 32, kb = it / nblk, nb = it % nblk, k0 = 64 * kb, n0 = 32 * nb;
    int drow0 = n0;
    if (kind == 1) drow0 = 256 * (n0 >> 7) + (n0 & 127);
    else if (kind == 2) drow0 = 256 * (n0 >> 7) + 128 + (n0 & 127);
    else if (kind == 3) drow0 = n0 < 832 ? n0 : n0 + 192;
    transpose_item(W, K, N, WT, k0, n0, drow0, ksc, scr, lane);
}

__device__ __forceinline__ void gemv_task(const Args& a, int task, LAS unsigned char* lds, int tid, int wave, int lane) {
    const int l = task / 144, cg = task % 144, n0 = cg * 128;
    const LAS float* sv = (const LAS float*)(lds + PRO_SV_OFF); LAS float* red = (LAS float*)(lds + PRO_RED_OFF);
    const float* W = a.in[4] + (size_t)l * DM * MODW + n0 + 2 * lane;
    f32x2 acc[NSTREAM];
#pragma unroll
    for (int s = 0; s < NSTREAM; ++s) acc[s] = (f32x2){0.f, 0.f};
    const int k0 = wave * 256;
#pragma unroll 2
    for (int kk = 0; kk < 256; kk += 4) {
        f32x2 wv[4];
#pragma unroll
        for (int i = 0; i < 4; ++i) wv[i] = *(const f32x2*)(W + (size_t)(k0 + kk + i) * MODW);
#pragma unroll
        for (int s = 0; s < NSTREAM; ++s) { const f32x4 c4 = *(const LAS f32x4*)(sv + s * 2048 + k0 + kk);
            acc[s] += wv[0] * c4[0] + wv[1] * c4[1] + wv[2] * c4[2] + wv[3] * c4[3]; }
    }
    float* modl = (float*)(a.ws + WS_MOD) + (size_t)l * NSTREAM * MODW;
    const float* bada = a.in[5] + (size_t)l * MODW;
    constexpr int RS = 5;
#pragma unroll
    for (int r = 0; r < 4; ++r) {
        const int s0 = r * RS;
#pragma unroll
        for (int q = 0; q < RS; ++q) if (s0 + q < NSTREAM) *(LAS f32x2*)(red + (wave * RS + q) * 128 + 2 * lane) = acc[(s0 + q) < NSTREAM ? (s0 + q) : 0];
        __syncthreads();
        const int ns = (NSTREAM - s0) < RS ? (NSTREAM - s0) : RS;
        for (int idx = tid; idx < ns * 128; idx += NWAVES * 64) { const int q = idx >> 7, n = idx & 127; float sum = 0.f;
#pragma unroll
            for (int w = 0; w < NWAVES; ++w) sum += red[(w * RS + q) * 128 + n];
            modl[(size_t)(s0 + q) * MODW + n0 + n] = sum + bada[n0 + n]; }
        __syncthreads();
    }
}
__device__ __forceinline__ void table_task(const Args& a, int tt, int tid) {
    float* t64c = (float*)(a.ws + WS_T64C); float* t64s = (float*)(a.ws + WS_T64S); float* t128c = (float*)(a.ws + WS_T128C); float* t128s = (float*)(a.ws + WS_T128S);
    for (int q = 0; q < 16; ++q) { const int e = tt * 8192 + q * 512 + tid;
        int pos, i, nf; float *cd, *sd;
        if (e < 65536) { pos = e >> 5; i = e & 31; nf = 16; cd = t64c + e; sd = t64s + e; } else { const int e2 = e - 65536; pos = e2 >> 6; i = e2 & 63; nf = 32; cd = t128c + e2; sd = t128s + e2; }
        const int r = pos >> 6, col = pos & 63; const int f = i < nf ? i : i - nf; const float p = (float)(i < nf ? r : col);
        const float inv = powf(10000.0f, -(float)f / (float)nf); const float ang = p * inv;
        *cd = cosf(ang); *sd = sinf(ang); }
}

__device__ __forceinline__ void prologue(const Args& a, LAS unsigned char* lds, volatile LAS unsigned* MISC, int tid_in, int wave, int lane_in) {
    int tid = tid_in, lane = lane_in; asm volatile("" : "+v"(tid), "+v"(lane));
    gu32* ctl = (gu32*)(a.ws + WS_CTL);
    bool sv_built = false;
    for (;;) {
        if (tid == 0) MISC[16] = __hip_atomic_fetch_add(ctl + CW_QUEUE, 1u, RLX_AGENT);
        __syncthreads();
        const int t = (int)MISC[16];
        __syncthreads();
        if (t >= N_TASKS) break;
        if (t < N_GEMV_TASKS) {
            if (!sv_built) {
                LAS float* sv = (LAS float*)(lds + PRO_SV_OFF);
                for (int e = tid; e < NSTREAM * DM; e += NWAVES * 64) { const int s = e >> 11, k = e & 2047; const float x = s < 16 ? a.in[1][s * DM + k] : a.in[3][k]; sv[e] = x / (1.0f + expf(-x)); }
                __syncthreads(); sv_built = true;
            }
            gemv_task(a, t, lds, tid, wave, lane);
        } else if (t < T_PAD) {
            sv_built = false;
            LAS float* scr = (LAS float*)(lds + wave * 8448);
            const int item0 = (t - T_CONV0) * CONV_CHUNK + wave * 8;
#pragma unroll 1
            for (int q = 0; q < 8; ++q) conv_item(a, item0 + q, scr, lane);
        } else if (t == T_PAD) {
            u32x4* p = (u32x4*)((bf16*)(a.ws + WS_WINE) + (size_t)832 * DM);
            for (int i = tid; i < 192 * DM * 2 / 16; i += NWAVES * 64) p[i] = (u32x4){0u, 0u, 0u, 0u};
        } else table_task(a, t - T_TAB0, tid);
    }
}

template <bool DO_LN, bool WRITE_H>
__device__ __forceinline__ void row_pass(const float* src_lat, const float* src_ctx, float* x_lat, float* x_ctx, int nrows, const float* lng, const float* lnb,
                                         const float* modl, int jn, bf16* H, int gw, int NGW, int lane_in) {
    int lane = lane_in; asm volatile("" : "+v"(lane));
    for (int row = gw; row < nrows; row += NGW) {
        const bool lat = row < M_LAT; const int s = lat ? (row >> 11) : 16; const size_t ro = lat ? (size_t)row * DM : (size_t)(row - M_LAT) * DM;
        const f32x4* src = (const f32x4*)((lat ? src_lat : src_ctx) + ro) + lane;
        f32x4 v[8];
#pragma unroll
        for (int j = 0; j < 8; ++j) v[j] = src[64 * j];
        if constexpr (DO_LN) {
            float sm = 0.f;
#pragma unroll
            for (int j = 0; j < 8; ++j) sm += (v[j].x + v[j].y) + (v[j].z + v[j].w);
            const float mean = wave_sum(sm) * (1.0f / DM); float s2 = 0.f;
#pragma unroll
            for (int j = 0; j < 8; ++j) { v[j] = v[j] - mean; s2 += (v[j].x * v[j].x + v[j].y * v[j].y) + (v[j].z * v[j].z + v[j].w * v[j].w); }
            const float rstd = 1.0f / sqrtf(wave_sum(s2) * (1.0f / DM) + LN_EPS);
            f32x4* dst = (f32x4*)((lat ? x_lat : x_ctx) + ro) + lane;
#pragma unroll
            for (int j = 0; j < 8; ++j) { const f32x4 g4 = ((const f32x4*)lng)[lane + 64 * j], b4 = ((const f32x4*)lnb)[lane + 64 * j]; v[j] = v[j] * rstd * g4 + b4; dst[64 * j] = v[j]; }
        }
        if constexpr (WRITE_H) {
            const f32x4* sh = (const f32x4*)(modl + (size_t)s * MODW + (size_t)(jn * 3) * DM) + lane; const f32x4* sc = sh + DM / 4;
            u32x2* hd = (u32x2*)(H + (size_t)row * DM) + lane;
#pragma unroll
            for (int j = 0; j < 8; ++j) { const f32x4 s4 = sh[64 * j], c4 = sc[64 * j]; const f32x4 hv = v[j] * (c4 + 1.0f) + s4;
                u32x2 w; w.x = cvt_pk_bf16(hv.x, hv.y); w.y = cvt_pk_bf16(hv.z, hv.w); hd[64 * j] = w; }
        }
    }
}
__device__ __forceinline__ void head128(bf16* hp, int li, bool active, const float* gain, bool rope, const float* tc, const float* ts) {
    u32x2 a = {0u, 0u}, b = {0u, 0u};
    if (active) { a = *(const u32x2*)(hp + 4 * li); b = *(const u32x2*)(hp + 64 + 4 * li); }
    float x1[4] = {bflo(a.x), bfhi(a.x), bflo(a.y), bfhi(a.y)}, x2[4] = {bflo(b.x), bfhi(b.x), bflo(b.y), bfhi(b.y)};
    if (gain) {
        float ss = 0.f;
#pragma unroll
        for (int i = 0; i < 4; ++i) ss += x1[i] * x1[i] + x2[i] * x2[i];
        ss += __shfl_xor(ss, 1); ss += __shfl_xor(ss, 2); ss += __shfl_xor(ss, 4); ss += __shfl_xor(ss, 8);
        const float rstd = 1.0f / sqrtf(ss * (1.0f / 128.0f) + LN_EPS);
        const f32x4 g1 = *(const f32x4*)(gain + 4 * li), g2 = *(const f32x4*)(gain + 64 + 4 * li);
#pragma unroll
        for (int i = 0; i < 4; ++i) { x1[i] *= rstd * g1[i]; x2[i] *= rstd * g2[i]; }
    }
    if (rope) {
        const f32x4 c = *(const f32x4*)(tc + 4 * li), s = *(const f32x4*)(ts + 4 * li);
#pragma unroll
        for (int i = 0; i < 4; ++i) { const float o1 = x1[i] * c[i] - x2[i] * s[i], o2 = x2[i] * c[i] + x1[i] * s[i]; x1[i] = o1; x2[i] = o2; }
    }
    if (active) { u32x2 w1, w2; w1.x = cvt_pk_bf16(x1[0], x1[1]); w1.y = cvt_pk_bf16(x1[2], x1[3]); w2.x = cvt_pk_bf16(x2[0], x2[1]); w2.y = cvt_pk_bf16(x2[2], x2[3]);
        *(u32x2*)(hp + 4 * li) = w1; *(u32x2*)(hp + 64 + 4 * li) = w2; }
}
__device__ __forceinline__ void pe_even(const Args& a, int gw, int NGW, int lane_in) {
    int lane = lane_in; asm volatile("" : "+v"(lane));
    bf16* INE = (bf16*)(a.ws + WS_INE); bf16* KMLA = (bf16*)(a.ws + WS_KMLA); float* rq = (float*)(a.ws + WS_RSTD); float* rkv = rq + M_ALL;
    const float* t64c = (const float*)(a.ws + WS_T64C); const float* t64s = (const float*)(a.ws + WS_T64S); const float* t128c = (const float*)(a.ws + WS_T128C); const float* t128s = (const float*)(a.ws + WS_T128S);
    const float* gq = a.in[16]; const float* gk = a.in[17];
    const int grp = lane >> 4, li = lane & 15;
    for (int row = gw; row < M_ALL; row += NGW) {
        bf16* base = INE + (size_t)row * INE_LD; const bool lat = row < M_LAT; const int pos = row & (SEQ - 1);
        { const u32x4 q8 = *(const u32x4*)(base + 8 * lane); float ss = 0.f;
#pragma unroll
          for (int i = 0; i < 4; ++i) { const float lo = bflo(q8[i]), hi = bfhi(q8[i]); ss += lo * lo + hi * hi; }
          ss = wave_sum(ss); if (lane == 0) rq[row] = 1.0f / sqrtf(ss * (1.0f / 512.0f) + LN_EPS); }
        { const u32x2 c4 = *(const u32x2*)(base + 512 + 4 * lane); float ss = 0.f;
#pragma unroll
          for (int i = 0; i < 2; ++i) { const float lo = bflo(c4[i]), hi = bfhi(c4[i]); ss += lo * lo + hi * hi; }
          ss = wave_sum(ss); if (lane == 0) rkv[row] = 1.0f / sqrtf(ss * (1.0f / 256.0f) + LN_EPS); }
        if (lane < 32) { float x1 = bf2f(base[768 + lane]), x2 = bf2f(base[800 + lane]);
            if (lat) { const float c = t64c[pos * 32 + lane], s = t64s[pos * 32 + lane]; const float o1 = x1 * c - x2 * s, o2 = x2 * c + x1 * s; x1 = o1; x2 = o2; }
            const bf16 b1 = (bf16)(cvt_pk_bf16(x1, 0.f) & 0xffffu), b2 = (bf16)(cvt_pk_bf16(x2, 0.f) & 0xffffu); bf16* kd = KMLA + (size_t)row * 1536 + 128 + lane;
#pragma unroll
            for (int h = 0; h < 8; ++h) { kd[h * 192] = b1; kd[h * 192 + 32] = b2; } }
        const float* tc = t128c + pos * 64; const float* ts = t128s + pos * 64;
        head128(base + 1024 + grp * 128, li, true, gq, lat, tc, ts);
        head128(base + 1024 + (4 + grp) * 128, li, true, gq, lat, tc, ts);
        head128(base + 2048 + (grp & 1) * 128, li, grp < 2, gk, lat, tc, ts);
    }
}
__device__ __forceinline__ void pe_odd(const Args& a, int gw, int NGW, int lane_in) {
    int lane = lane_in; asm volatile("" : "+v"(lane));
    bf16* INO = (bf16*)(a.ws + WS_INO); const float* t128c = (const float*)(a.ws + WS_T128C); const float* t128s = (const float*)(a.ws + WS_T128S);
    const int grp = lane >> 4, li = lane & 15;
    for (int row = gw; row < M_LAT; row += NGW) {
        bf16* base = INO + (size_t)row * INO_LD; const int pos = row & (SEQ - 1); const float* tc = t128c + pos * 64; const float* ts = t128s + pos * 64;
#pragma unroll
        for (int it = 0; it < 8; ++it) head128(base + (it < 4 ? 0 : 2048) + ((it & 3) * 4 + grp) * 128, li, true, nullptr, true, tc, ts);
    }
}
__device__ __forceinline__ void pt_odd(const Args& a, int gw, int NGW, int lane_in) {
    int lane = lane_in; asm volatile("" : "+v"(lane));
    bf16* OD = (bf16*)(a.ws + WS_OD);
    float d1 = a.in[20][lane] * a.in[21][lane] + a.in[20][lane + 64] * a.in[21][lane + 64], d2 = a.in[22][lane] * a.in[23][lane] + a.in[22][lane + 64] * a.in[23][lane + 64];
    d1 = wave_sum(d1); d2 = wave_sum(d2);
    const float lam = expf(d1) - expf(d2) + LAMBDA_INIT;
    const f32x4 g4 = *(const f32x4*)(a.in[24] + 4 * lane);
    for (int row = gw; row < M_LAT; row += NGW) {
        bf16* base = OD + (size_t)row * 4096; u32x2 o0[8], o1[8];
#pragma unroll
        for (int h = 0; h < 8; ++h) { o0[h] = *(const u32x2*)(base + h * 512 + 4 * lane); o1[h] = *(const u32x2*)(base + h * 512 + 256 + 4 * lane); }
        asm volatile("s_waitcnt vmcnt(0)" ::: "memory");
#pragma unroll
        for (int h = 0; h < 8; ++h) {
            float y[4] = {bflo(o0[h].x) - lam * bflo(o1[h].x), bfhi(o0[h].x) - lam * bfhi(o1[h].x), bflo(o0[h].y) - lam * bflo(o1[h].y), bfhi(o0[h].y) - lam * bfhi(o1[h].y)};
            float ss = y[0] * y[0] + y[1] * y[1] + y[2] * y[2] + y[3] * y[3]; ss = wave_sum(ss);
            const float sc = (1.0f - LAMBDA_INIT) / sqrtf(ss * (1.0f / 256.0f) + LN_EPS);
            u32x2 w; w.x = cvt_pk_bf16(y[0] * sc * g4[0], y[1] * sc * g4[1]); w.y = cvt_pk_bf16(y[2] * sc * g4[2], y[3] * sc * g4[3]);
            *(u32x2*)(base + h * 256 + 4 * lane) = w; }
    }
}

#ifndef A192_SD
#define A192_SD 1
#endif
#ifndef A128_SD
#define A128_SD 2
#endif
#ifndef A192_ROPE
#define A192_ROPE true
#endif
#ifndef IT_MAX
#define IT_MAX 4
#endif
__global__ void __launch_bounds__(NWAVES * 64, 2) fwd(Args a) {
    extern __shared__ __attribute__((aligned(16))) unsigned char lds_raw[];
    LAS unsigned char* lds = (LAS unsigned char*)lds_raw;
    volatile LAS unsigned* MISC = (volatile LAS unsigned*)(lds + MISC_OFF);
    const int tid = threadIdx.x, lane = tid & 63, wave = __builtin_amdgcn_readfirstlane(tid >> 6);
    const int G = gridDim.x, bx = blockIdx.x, vcu = (G % 8 == 0) ? (bx % 8) * (G / 8) + bx / 8 : bx;
    const int gw = vcu * NWAVES + wave, NGW = G * NWAVES;
    if (tid < 64) MISC[tid] = 0u;
    __syncthreads();
    unsigned char* ws0 = a.ws;
    XcdBarrier bar = xcd_barrier_post((unsigned*)(ws0 + WS_CTL) + CW_BAR, MISC + 8);
    float* OUT = a.out;

#ifndef DIS_PRO
    prologue(a, lds, MISC, tid, wave, lane);
#endif
    xcd_barrier(bar);
    row_pass<false, true>(a.in[0], a.in[2], nullptr, nullptr, M_ALL, nullptr, nullptr, (const float*)(ws0 + WS_MOD), 0, (bf16*)(ws0 + WS_H), gw, NGW, lane);
    xcd_barrier(bar);

#ifdef UNROLL_IT
#pragma unroll
#else
#pragma unroll 1
#endif
    for (int it = 0; it < IT_MAX; ++it) {
        const int l = it >> 1, f = it & 1, j = 2 * f; const int Mrows = (it == 3) ? M_LAT : M_ALL;
        unsigned long zoff = 0; asm volatile("" : "+s"(zoff)); unsigned char* ws = ws0 + zoff;
        float* XCTX = (float*)(ws + WS_XCTX); bf16* H = (bf16*)(ws + WS_H); bf16* Gb = (bf16*)(ws + WS_G); const float* MOD = (const float*)(ws + WS_MOD);
        const float* modl = MOD + (size_t)l * NSTREAM * MODW;
        { pg8::Gemm g{H, (const bf16*)(ws + WS_WUP + (size_t)it * SZ_WUP), Mrows, 2 * FF, DM, DM, DM}; pg8::StaticOrder S; S.init(Mrows, 2 * FF, G, bx);
          pg8::EpiSwiglu E{Gb, FF};
#ifndef DIS_UP
 pg8::gemm_phase(lds, g, S, E);
#endif
 }
        xcd_barrier(bar);
        { pg8::Gemm g{Gb, (const bf16*)(ws + WS_WDN + (size_t)it * SZ_WDN), Mrows, DM, FF, FF, FF}; pg8::StaticOrder S; S.init(Mrows, DM, G, bx);
          pg8::EpiResid E{it == 0 ? a.in[0] : OUT, it == 0 ? a.in[2] : XCTX, OUT, XCTX, modl + (size_t)(j * 3 + 2) * DM, 0.5f};
#ifndef DIS_DN
 pg8::gemm_phase(lds, g, S, E);
#endif
 }
        xcd_barrier(bar);
        { const float* lng = a.in[6] + (size_t)(l * 3 + j) * DM; const float* lnb = a.in[7] + (size_t)(l * 3 + j) * DM;
          if (it == 3) row_pass<true, false>(OUT, XCTX, OUT, XCTX, M_LAT, lng, lnb, nullptr, 0, nullptr, gw, NGW, lane);
          else row_pass<true, true>(OUT, XCTX, OUT, XCTX, M_ALL, lng, lnb, f == 0 ? modl : modl + (size_t)NSTREAM * MODW, f == 0 ? 1 : 0, H, gw, NGW, lane); }
        if (it == 3) break;
        xcd_barrier(bar);
        if (f != 0) continue;
        const int Mq = (l == 0) ? M_ALL : M_LAT;
        if (l == 0) {
            { pg8::Gemm g{H, (const bf16*)(ws + WS_WINE), M_ALL, INE_LD, DM, DM, DM}; pg8::StaticOrder S; S.init(M_ALL, INE_LD, G, bx);
              bf16* o = (bf16*)(ws + WS_INE); pg8::EpiStore E{o, o + 128, INE_LD, INE_LD, 256, 256, nullptr};
#ifndef DIS_INE
 pg8::gemm_phase(lds, g, S, E);
#endif
 }
            xcd_barrier(bar);
            pe_even(a, gw, NGW, lane);
            xcd_barrier(bar);
            { const float* rq = (const float*)(ws + WS_RSTD);
              { pg8::Gemm g{(const bf16*)(ws + WS_INE), (const bf16*)(ws + WS_WUQ), M_ALL, 1536, 512, INE_LD, 512}; pg8::StaticOrder S; S.init(M_ALL, 1536, G, bx);
                bf16* o = (bf16*)(ws + WS_QMLA); pg8::EpiStore E{o, o + 128, 1536, 1536, 256, 256, rq};
#ifndef DIS_QUP
 pg8::gemm_phase(lds, g, S, E);
#endif
 }
              { pg8::Gemm g{(const bf16*)(ws + WS_INE) + 512, (const bf16*)(ws + WS_WUKV), M_ALL, 2048, 256, INE_LD, 256}; pg8::StaticOrder S; S.init(M_ALL, 2048, G, bx);
                pg8::EpiStore E{(bf16*)(ws + WS_KMLA), (bf16*)(ws + WS_VMLA), 1536, 1024, 192, 128, rq + M_ALL};
#ifndef DIS_KVUP
 pg8::gemm_phase(lds, g, S, E);
#endif
 } }
            xcd_barrier(bar);
            { const bf16* QM = (const bf16*)(ws + WS_QMLA); const bf16* KM = (const bf16*)(ws + WS_KMLA); const bf16* VM = (const bf16*)(ws + WS_VMLA);
              const float* t64c = (const float*)(ws + WS_T64C); const float* t64s = (const float*)(ws + WS_T64S);
#pragma unroll 1
              for (int u = vcu; u < 1152; u += G) {
                  const bf16 *Q, *Kc, *Kl, *Vc, *Vl; bf16* O; int NT; const float *rc = nullptr, *rs = nullptr;
                  if (u < 1024) { const int bh = u >> 3, qb = u & 7, b = bh >> 3, h = bh & 7; const size_t r0 = (size_t)b * SEQ + qb * 256, rc0 = (size_t)M_LAT + b * CTXL, rl0 = (size_t)b * SEQ;
                      Q = QM + r0 * 1536 + h * 192; O = H + r0 * DM + h * 128; Kc = KM + rc0 * 1536 + h * 192; Kl = KM + rl0 * 1536 + h * 192; Vc = VM + rc0 * 1024 + h * 128; Vl = VM + rl0 * 1024 + h * 128;
                      NT = 36; rc = t64c + qb * 256 * 32; rs = t64s + qb * 256 * 32; }
                  else { const int idx = u - 1024, b = idx >> 3, h = idx & 7; const size_t r0 = (size_t)M_LAT + b * CTXL;
                      Q = QM + r0 * 1536 + h * 192; O = H + r0 * DM + h * 128; Kc = KM + r0 * 1536 + h * 192; Kl = Kc; Vc = VM + r0 * 1024 + h * 128; Vl = Vc; NT = 4; }
#ifndef DIS_A192
                  att::attn_unit<192, A192_ROPE, A192_SD>(Q, 1536, Kc, Kl, 1536, Vc, Vl, 1024, 4, NT, O, DM, rc, rs, (LAS char*)lds);
#endif
              } }
        } else {
            { pg8::Gemm g{H, (const bf16*)(ws + WS_WINO), M_ALL, INO_LD, DM, DM, DM}; pg8::StaticOrder S; S.init(M_ALL, INO_LD, G, bx);
              bf16* o = (bf16*)(ws + WS_INO); pg8::EpiStore E{o, o + 128, INO_LD, INO_LD, 256, 256, nullptr};
#ifndef DIS_INO
 pg8::gemm_phase(lds, g, S, E);
#endif
 }
            xcd_barrier(bar);
            pe_odd(a, gw, NGW, lane);
            xcd_barrier(bar);
        }
        { const int NU = (l == 0) ? 1152 : 4096;
#pragma unroll 1
          for (int uu = (l == 0) ? (vcu + G / 2) % G : vcu; uu < NU; uu += G) {
              const bf16 *Q, *Kc, *Kl, *Vc, *Vl; bf16* O; int NT, ldq, ldk, ldo;
              if (l == 0) {
                  const bf16* IE = (const bf16*)(ws + WS_INE); ldq = INE_LD; ldk = INE_LD; ldo = DM;
                  const int u = uu;
                  if (uu < 1024) { const int bh = u >> 3, qb = u & 7, b = bh >> 3, hq = bh & 7, kvh = hq >> 2; const size_t r0 = (size_t)b * SEQ + qb * 256, rc0 = (size_t)M_LAT + b * CTXL, rl0 = (size_t)b * SEQ;
                      Q = IE + r0 * INE_LD + 1024 + hq * 128; O = H + r0 * DM + 1024 + hq * 128; Kc = IE + rc0 * INE_LD + 2048 + kvh * 128; Kl = IE + rl0 * INE_LD + 2048 + kvh * 128; Vc = Kc + 256; Vl = Kl + 256; NT = 36; }
                  else { const int idx = u - 1024, b = idx >> 3, hq = idx & 7, kvh = hq >> 2; const size_t r0 = (size_t)M_LAT + b * CTXL;
                      Q = IE + r0 * INE_LD + 1024 + hq * 128; O = H + r0 * DM + 1024 + hq * 128; Kc = IE + r0 * INE_LD + 2048 + kvh * 128; Kl = Kc; Vc = Kc + 256; Vl = Vc; NT = 4; }
              } else {
                  const bf16* IO = (const bf16*)(ws + WS_INO); bf16* OD = (bf16*)(ws + WS_OD); ldq = INO_LD; ldk = INO_LD; ldo = 4096;
                  const int qb = uu & 7, vh = (uu >> 3) & 1, hq = (uu >> 4) & 15, b = uu >> 8; const size_t r0 = (size_t)b * SEQ + qb * 256, rc0 = (size_t)M_LAT + b * CTXL, rl0 = (size_t)b * SEQ;
                  Q = IO + r0 * INO_LD + hq * 128; Kc = IO + rc0 * INO_LD + 2048 + hq * 128; Kl = IO + rl0 * INO_LD + 2048 + hq * 128;
                  Vc = IO + rc0 * INO_LD + 4096 + (hq >> 1) * 256 + vh * 128; Vl = IO + rl0 * INO_LD + 4096 + (hq >> 1) * 256 + vh * 128;
                  O = OD + r0 * 4096 + (hq >> 1) * 512 + (hq & 1) * 256 + vh * 128; NT = 36;
              }
#ifndef DIS_A128
              att::attn_unit<128, false, A128_SD>(Q, ldq, Kc, Kl, ldk, Vc, Vl, ldk, 4, NT, O, ldo, nullptr, nullptr, (LAS char*)lds);
#endif
          } }
        xcd_barrier(bar);
        if (l == 1) { pt_odd(a, gw, NGW, lane); xcd_barrier(bar); }
        { pg8::Gemm g{l == 0 ? H : (const bf16*)(ws + WS_OD), (const bf16*)(ws + (l == 0 ? WS_WOE : WS_WOO)), Mq, DM, DM, l == 0 ? DM : 4096, DM}; pg8::StaticOrder S; S.init(Mq, DM, G, bx);
          pg8::EpiResid E{OUT, XCTX, OUT, XCTX, modl + (size_t)(1 * 3 + 2) * DM, 1.0f};
#ifndef DIS_OUT
 pg8::gemm_phase(lds, g, S, E);
#endif
 }
        xcd_barrier(bar);
        { const float* lng = a.in[6] + (size_t)(l * 3 + 1) * DM; const float* lnb = a.in[7] + (size_t)(l * 3 + 1) * DM;
          row_pass<true, true>(OUT, XCTX, OUT, XCTX, Mq, lng, lnb, modl, 2, H, gw, NGW, lane); }
        xcd_barrier(bar);
    }
}

extern "C" void kernel_launch(void* const* d_in, const int* in_sizes, int n_in, void* d_out, int out_size, void* d_ws, size_t ws_size, hipStream_t stream) {
    static int grid = 0;
    if (grid == 0) {
        if (n_in != 26 || in_sizes[0] != M_LAT * DM || out_size != M_LAT * DM || ws_size < WS_END) {
            fprintf(stderr, "kernel_launch: shape/workspace mismatch: n_in %d in0 %d out %d ws %zu (need %zu); nothing launched\n", n_in, n_in > 0 ? in_sizes[0] : -1, out_size, ws_size, (size_t)WS_END); grid = -1; return; }
        int dev = 0, cus = 0, per_cu = 0;
        if (hipGetDevice(&dev) != hipSuccess || hipDeviceGetAttribute(&cus, hipDeviceAttributeMultiprocessorCount, dev) != hipSuccess) { fprintf(stderr, "kernel_launch: device query failed\n"); grid = -1; return; }
        if (hipFuncSetAttribute((const void*)fwd, hipFuncAttributeMaxDynamicSharedMemorySize, LDS_BYTES) != hipSuccess) { fprintf(stderr, "kernel_launch: hipFuncSetAttribute(%d B LDS) failed\n", LDS_BYTES); grid = -1; return; }
        if (hipOccupancyMaxActiveBlocksPerMultiprocessor(&per_cu, (const void*)fwd, NWAVES * 64, LDS_BYTES) != hipSuccess || per_cu < 1)
            fprintf(stderr, "kernel_launch: note: occupancy query reports %d workgroups per CU\n", per_cu);
        (void)hipGetLastError();
        grid = cus;
    }
    if (grid < 0) return;
    if (hipMemsetAsync((char*)d_ws + WS_CTL, 0, CTL_ZERO_BYTES, stream) != hipSuccess) { fprintf(stderr, "kernel_launch: memset failed\n"); return; }
    Args a{};
    for (int i = 0; i < 26; ++i) a.in[i] = (const float*)d_in[i];
    a.out = (float*)d_out; a.ws = (unsigned char*)d_ws;
    hipLaunchKernelGGL(fwd, dim3(grid), dim3(NWAVES * 64), LDS_BYTES, stream, a);
    const hipError_t le = hipPeekAtLastError();
    if (le != hipSuccess) fprintf(stderr, "kernel_launch: launch failed: %s\n", hipGetErrorName(le));
}
```
